# Optimizing an MI355X kernel written in HIP

```python
import jax, jax.numpy as jnp
from jax import lax
import numpy as np

D_MODEL = 1024
BATCH = 4
SEQ = 4096
DEPTH = 2
DEC_BATCH = 128
DEC_SEQ = 4
PAST_LEN = 8192
PAGE_SIZE = 128

WINDOW = 128
SWA_BLOCK = WINDOW
HD_A = 64
HQ_A = 8
HKV_A = 2
G_A = HQ_A // HKV_A
H_B = 4
DK_B = 64
DV_B = 128
GATE_RANK = 16
GATE_TAU = 16.0
GLA_CHUNK = 64
CONV_W = 3
D_FF = ((8 * D_MODEL // 3 + 127) // 128) * 128
N_EVEN = (DEPTH + 1) // 2
N_ODD = DEPTH // 2
EPS = 1e-6
SPLIT_EVEN = (HQ_A * HD_A, HKV_A * HD_A, HKV_A * HD_A, H_B * DK_B, H_B * DK_B, H_B * DV_B, H_B * DV_B, GATE_RANK)
D_IN_EVEN = sum(SPLIT_EVEN)
D_MIX_EVEN = HQ_A * HD_A + H_B * DV_B

kernel_name = "hybrid_swa_gla_shortconv_convffn_step"


def rmsnorm(x, g):
    x32 = x.astype(jnp.float32)
    y = x32 * lax.rsqrt(jnp.mean(x32 * x32, axis=-1, keepdims=True) + EPS) * g.astype(jnp.float32)
    return y.astype(x.dtype)


def alibi_slopes(n):
    return jnp.asarray(2.0 ** (-8.0 * np.arange(1, n + 1) / n), dtype=jnp.float32)


def causal_dwconv(x, past, w):
    L = x.shape[1]
    xp = jnp.concatenate([past.astype(x.dtype), x], axis=1)
    y = w[0] * xp[:, 0:L]
    for i in range(1, CONV_W):
        y = y + w[i] * xp[:, i:i + L]
    return y, xp[:, L:]


def sink_attention(q, k, v, dist, valid, slopes, sinks):
    s = jnp.einsum('nbqkgd,nbskd->nbkgqs', q, k).astype(jnp.float32) * (HD_A ** -0.5)
    s = s - slopes.reshape(HKV_A, G_A, 1, 1) * dist.astype(jnp.float32)
    s = jnp.where(valid[None, :, None, None], s, -jnp.inf)
    sink = jnp.broadcast_to(sinks.astype(jnp.float32).reshape(HKV_A, G_A, 1, 1), s.shape[:-1] + (1,))
    p = jax.nn.softmax(jnp.concatenate([s, sink], axis=-1), axis=-1)[..., :-1]
    return jnp.einsum('nbkgqs,nbskd->nbqkgd', p.astype(v.dtype), v)


def swa_prompt(q, k, v, slopes, sinks):
    N, S, _ = q.shape
    nb = S // SWA_BLOCK
    qb = q.reshape(N, nb, SWA_BLOCK, HKV_A, G_A, HD_A)

    def with_prev(t):
        tb = t.reshape(N, nb, SWA_BLOCK, HKV_A, HD_A)
        prev = jnp.pad(tb, ((0, 0), (1, 0), (0, 0), (0, 0), (0, 0)))[:, :-1]
        return jnp.concatenate([prev, tb], axis=2)

    qi = jnp.arange(SWA_BLOCK)[:, None]
    sj = jnp.arange(2 * SWA_BLOCK)[None, :]
    dist = SWA_BLOCK + qi - sj
    blk = jnp.arange(nb)[:, None, None]
    valid = (dist >= 0) & (dist <= WINDOW) & ((blk - 1) * SWA_BLOCK + sj >= 0)
    o = sink_attention(qb, with_prev(k), with_prev(v), dist, valid, slopes, sinks)
    return o.reshape(N, S, HQ_A * HD_A)


def swa_decode(q, k, v, buf_k, buf_v, slopes, sinks):
    N, L, _ = q.shape
    kk = jnp.concatenate([buf_k.astype(k.dtype), k], axis=1)
    vv = jnp.concatenate([buf_v.astype(v.dtype), v], axis=1)
    dist = WINDOW + jnp.arange(L)[:, None] - jnp.arange(WINDOW + L)[None, :]
    valid = ((dist >= 0) & (dist <= WINDOW))[None]
    o = sink_attention(q.reshape(N, 1, L, HKV_A, G_A, HD_A), kk[:, None], vv[:, None], dist, valid, slopes, sinks)
    return o.reshape(N, L, HQ_A * HD_A), kk[:, -WINDOW:], vv[:, -WINDOW:]


def gla_chunked(q, k, v, g, S0):
    N, L, H, dk = q.shape
    dv = v.shape[-1]
    nc = L // GLA_CHUNK
    to_chunks = lambda t: t.reshape(N, nc, GLA_CHUNK, H, t.shape[-1]).transpose(1, 0, 2, 3, 4)
    mask = jnp.tril(jnp.ones((GLA_CHUNK, GLA_CHUNK), dtype=bool))[None, :, :, None, None]

    def step(S, inp):
        qc, kc, vc, gc = inp
        b = jnp.cumsum(gc, axis=1)
        o_inter = jnp.einsum('nchd,nhde->nche', qc * jnp.exp(b), S)
        decay = jnp.exp(jnp.where(mask, b[:, :, None] - b[:, None, :], -jnp.inf))
        A = jnp.einsum('nihd,njhd,nijhd->nhij', qc, kc, decay)
        o_intra = jnp.einsum('nhij,njhe->nihe', A, vc)
        bC = b[:, -1]
        S = jnp.exp(bC)[..., None] * S + jnp.einsum('nchd,nche->nhde', kc * jnp.exp(bC[:, None] - b), vc)
        return S, o_inter + o_intra

    S, o = lax.scan(step, S0, (to_chunks(q), to_chunks(k), to_chunks(v), to_chunks(g)))
    return o.transpose(1, 0, 2, 3, 4).reshape(N, L, H, dv), S


def gla_recurrent(q, k, v, g, S0):
    def step(S, inp):
        qt, kt, vt, gt = inp
        S = jnp.exp(gt)[..., None] * S + kt[..., None] * vt[..., None, :]
        return S, jnp.einsum('nhd,nhde->nhe', qt, S)

    S, o = lax.scan(step, S0, tuple(jnp.swapaxes(t, 0, 1) for t in (q, k, v, g)))
    return jnp.swapaxes(o, 0, 1), S


def even_mixer(h, w_in, w_gate_up, b_gate, sinks, gla_norm, w_out, past):
    f32 = jnp.float32
    N, L, _ = h.shape
    idx = list(np.cumsum(SPLIT_EVEN)[:-1])
    qa, ka, va, qb, kb, vb, rb, glr = jnp.split(h @ w_in, idx, axis=-1)
    slopes = alibi_slopes(HQ_A)
    ka = ka.reshape(N, L, HKV_A, HD_A)
    va = va.reshape(N, L, HKV_A, HD_A)
    qb = qb.reshape(N, L, H_B, DK_B).astype(f32) * (DK_B ** -0.5)
    kb = kb.reshape(N, L, H_B, DK_B).astype(f32)
    vb = vb.reshape(N, L, H_B, DV_B).astype(f32)
    gb = (jax.nn.log_sigmoid((glr @ w_gate_up + b_gate).astype(f32)) / GATE_TAU).reshape(N, L, H_B, DK_B)
    if past is None:
        oa = swa_prompt(qa, ka, va, slopes, sinks)
        new_k, new_v = ka[:, -WINDOW:], va[:, -WINDOW:]
        ob, S = gla_chunked(qb, kb, vb, gb, jnp.zeros((N, H_B, DK_B, DV_B), f32))
    else:
        buf_k, buf_v, S0 = past
        oa, new_k, new_v = swa_decode(qa, ka, va, buf_k, buf_v, slopes, sinks)
        ob, S = gla_recurrent(qb, kb, vb, gb, S0.astype(f32))
    ob = ob * lax.rsqrt(jnp.mean(ob * ob, axis=-1, keepdims=True) + EPS)
    ob = ob.reshape(N, L, H_B * DV_B) * gla_norm.astype(f32) * jax.nn.silu(rb.astype(f32))
    y = jnp.concatenate([oa.astype(h.dtype), ob.astype(h.dtype)], axis=-1) @ w_out
    return y, new_k, new_v, S


def odd_mixer(h, w_in, conv_w, w_out, past):
    bg, cg, u = jnp.split(h @ w_in, 3, axis=-1)
    z, new = causal_dwconv(cg * u, past, conv_w)
    return (bg * z) @ w_out, new


def conv_ffn(h, w_up, conv_w, conv_b, w_down, past):
    u = h @ w_up
    uc, new = causal_dwconv(u, past, conv_w)
    gate, val = jnp.split(uc + conv_b, 2, axis=-1)
    return (jax.nn.gelu(gate, approximate=True) * val) @ w_down, new


def trunk(x, past, weights):
    (norm_mix_pre, norm_mix_post, norm_ffn_pre, norm_ffn_post, w_in_even, w_gate_up, b_gate, attn_sinks,
     gla_norm, w_out_even, w_in_odd, conv_w_odd, w_out_odd, ffn_up, ffn_conv_w, ffn_conv_b, ffn_down) = weights
    N = x.shape[0]
    ks, vs, gs, cs, fs = [], [], [], [], []
    for l in range(DEPTH):
        h = rmsnorm(x, norm_mix_pre[l])
        if l % 2 == 0:
            e = l // 2
            p = None if past is None else (past[0][e], past[1][e], past[2][e])
            m, nk, nv, S = even_mixer(h, w_in_even[e], w_gate_up[e], b_gate[e], attn_sinks[e], gla_norm[e],
                                      w_out_even[e], p)
            ks.append(nk)
            vs.append(nv)
            gs.append(S)
        else:
            o = l // 2
            p = jnp.zeros((N, CONV_W - 1, D_MODEL), x.dtype) if past is None else past[3][o]
            m, nc = odd_mixer(h, w_in_odd[o], conv_w_odd[o], w_out_odd[o], p)
            cs.append(nc)
        x = x + rmsnorm(m, norm_mix_post[l])
        h = rmsnorm(x, norm_ffn_pre[l])
        p = jnp.zeros((N, CONV_W - 1, 2 * D_FF), x.dtype) if past is None else past[4][l]
        f, nf = conv_ffn(h, ffn_up[l], ffn_conv_w[l], ffn_conv_b[l], ffn_down[l], p)
        fs.append(nf)
        x = x + rmsnorm(f, norm_ffn_post[l])
    return x, jnp.stack(ks), jnp.stack(vs), jnp.stack(gs), jnp.stack(cs), jnp.stack(fs)


def setup_inputs(seed: int = 0) -> dict:
    key = jax.random.key(seed)
    ks = jax.random.split(key, 24)
    f32 = jnp.float32
    D = D_MODEL
    F2 = 2 * D_FF

    def nrm(k, shape, scale):
        return jax.random.normal(k, shape, f32) * scale

    return {
        "x_prompt": nrm(ks[0], (BATCH, SEQ, D), 1.0),
        "x_sample": nrm(ks[1], (DEC_BATCH, DEC_SEQ, D), 1.0),
        "cache_swa_k": nrm(ks[2], (N_EVEN, DEC_BATCH, WINDOW, HKV_A, HD_A), 1.0),
        "cache_swa_v": nrm(ks[3], (N_EVEN, DEC_BATCH, WINDOW, HKV_A, HD_A), 1.0),
        "state_gla": nrm(ks[4], (N_EVEN, DEC_BATCH, H_B, DK_B, DV_B), 0.5),
        "state_conv": nrm(ks[5], (N_ODD, DEC_BATCH, CONV_W - 1, D), 1.0),
        "state_ffn": nrm(ks[6], (DEPTH, DEC_BATCH, CONV_W - 1, F2), 1.0),
        "norm_mix_pre": 1.0 + nrm(ks[7], (DEPTH, D), 0.05),
        "norm_mix_post": 1.0 + nrm(ks[8], (DEPTH, D), 0.05),
        "norm_ffn_pre": 1.0 + nrm(ks[9], (DEPTH, D), 0.05),
        "norm_ffn_post": 1.0 + nrm(ks[10], (DEPTH, D), 0.05),
        "w_in_even": nrm(ks[11], (N_EVEN, D, D_IN_EVEN), D ** -0.5),
        "w_gate_up": nrm(ks[12], (N_EVEN, GATE_RANK, H_B * DK_B), GATE_RANK ** -0.5),
        "b_gate": nrm(ks[13], (N_EVEN, H_B * DK_B), 0.1),
        "attn_sinks": nrm(ks[14], (N_EVEN, HQ_A), 0.5),
        "gla_norm": 1.0 + nrm(ks[15], (N_EVEN, H_B * DV_B), 0.05),
        "w_out_even": nrm(ks[16], (N_EVEN, D_MIX_EVEN, D), D_MIX_EVEN ** -0.5),
        "w_in_odd": nrm(ks[17], (N_ODD, D, 3 * D), D ** -0.5),
        "conv_w_odd": nrm(ks[18], (N_ODD, CONV_W, D), CONV_W ** -0.5),
        "w_out_odd": nrm(ks[19], (N_ODD, D, D), D ** -0.5),
        "ffn_up": nrm(ks[20], (DEPTH, D, F2), D ** -0.5),
        "ffn_conv_w": nrm(ks[21], (DEPTH, CONV_W, F2), CONV_W ** -0.5),
        "ffn_conv_b": nrm(ks[22], (DEPTH, F2), 0.02),
        "ffn_down": nrm(ks[23], (DEPTH, D_FF, D), D_FF ** -0.5),
    }


def reference(x_prompt, x_sample, cache_swa_k, cache_swa_v, state_gla, state_conv, state_ffn,
              norm_mix_pre, norm_mix_post, norm_ffn_pre, norm_ffn_post, w_in_even, w_gate_up, b_gate,
              attn_sinks, gla_norm, w_out_even, w_in_odd, conv_w_odd, w_out_odd, ffn_up, ffn_conv_w,
              ffn_conv_b, ffn_down):
    weights = (norm_mix_pre, norm_mix_post, norm_ffn_pre, norm_ffn_post, w_in_even, w_gate_up, b_gate,
               attn_sinks, gla_norm, w_out_even, w_in_odd, conv_w_odd, w_out_odd, ffn_up, ffn_conv_w,
               ffn_conv_b, ffn_down)
    y_prompt, swa_k_p, swa_v_p, gla_p, conv_p, ffn_p = trunk(x_prompt, None, weights)
    y_sample, swa_k_s, swa_v_s, gla_s, conv_s, ffn_s = trunk(
        x_sample, (cache_swa_k, cache_swa_v, state_gla, state_conv, state_ffn), weights)
    return (y_prompt, y_sample, swa_k_p, swa_v_p, gla_p, conv_p, ffn_p, swa_k_s, swa_v_s, gla_s, conv_s, ffn_s)
```

```cpp
#include <hip/hip_runtime.h>
#include <cstdio>
#include <cstdint>
namespace pg8 {
#define PG8_LAS __attribute__((address_space(3)))
typedef unsigned short bf16_t;
typedef short bf16x8 __attribute__((ext_vector_type(8)));
typedef float f32x4 __attribute__((ext_vector_type(4)));
typedef unsigned u32x4 __attribute__((ext_vector_type(4)));
constexpr int BM = 256, BK = 64, HALF = 128, HTB = HALF * BK * 2  , STAGE_BYTES = 8 * HTB, NXCD = 8, WGM = 8;

__host__ __device__ __forceinline__ int lds_byte(int r, int c) { const int st = (r >> 4) * 2 + (c >> 5), rr = r & 15, cc = c & 31, ob = rr * 64 + cc * 2; return st * 1024 + (ob ^ (((ob >> 9) & 1) << 5)); }
__host__ __device__ __forceinline__ void stage_rc(int b, int& R, int& C) { const int st = b / 1024, sb = b % 1024, swz = sb ^ (((sb >> 9) & 1) << 5); R = (st >> 1) * 16 + swz / 64; C = (st & 1) * 32 + (swz % 64) / 2; }
__host__ __device__ __forceinline__ int perm32(int rho) { const int n = rho >> 4, i = rho & 15; return 8 * (i >> 2) + 4 * n + (i & 3); }

struct Unit { int pm, pn; };
struct Gemm { const bf16_t* A; const bf16_t* Bt; int M, N, K; };

struct StaticOrder {
    int nM, nN, nwg, G, c;
    __host__ __device__ void init(int M, int N, int G_, int c_) { nM = M / BM; nN = N / BM; nwg = nM * nN; G = G_; c = c_; }
    __host__ __device__ bool next(int i, Unit& u) const {
        const long L = (long)i * G + c; if (L >= nwg) return false;
        int wgid = (int)L; { const int q = nwg / NXCD, r = nwg % NXCD, xcd = wgid % NXCD, off = wgid / NXCD; wgid = (xcd < r ? xcd * (q + 1) : r * (q + 1) + (xcd - r) * q) + off; }
        const int nig = WGM * nN, gid = wgid / nig, fm = gid * WGM, gsz = (nM - fm) < WGM ? (nM - fm) : WGM;
        u.pm = fm + ((wgid % nig) % gsz); u.pn = (wgid % nig) / gsz; return true;
    }
    __device__ __forceinline__ void a_ready(const Unit&) const {}
    __device__ __forceinline__ void done(const Unit&) const {}
};

__device__ __forceinline__ unsigned cvt_pk_bf16(float lo, float hi) { unsigned r; asm volatile("v_cvt_pk_bf16_f32 %0, %1, %2" : "=v"(r) : "v"(lo), "v"(hi)); return r; }
typedef float f32x2 __attribute__((ext_vector_type(2)));
typedef unsigned u32x2 __attribute__((ext_vector_type(2)));
struct EpiStore {
    static constexpr bool PERM = true, AFTER_DRAIN = false;
    bf16_t* O; int ldc;
    __device__ __forceinline__ void operator()(const f32x4 (&acc)[2][2][4][2], const Unit& u, int wr, int wc, int fr, int fq) const {
        const int row0 = u.pm * BM + wr * 64 + fr, col0 = u.pn * BM + wc * 32 + 8 * fq;
#pragma unroll
        for (int ai = 0; ai < 2; ++ai)
#pragma unroll
            for (int m = 0; m < 4; ++m) { bf16_t* rowp = O + (size_t)(row0 + ai * HALF + m * 16) * ldc + col0;
#pragma unroll
                for (int bj = 0; bj < 2; ++bj) { const f32x4 v0 = acc[ai][bj][m][0], v1 = acc[ai][bj][m][1];
                    u32x4 w; w.x = cvt_pk_bf16(v0[0], v0[1]); w.y = cvt_pk_bf16(v0[2], v0[3]); w.z = cvt_pk_bf16(v1[0], v1[1]); w.w = cvt_pk_bf16(v1[2], v1[3]);
                    *(u32x4*)(rowp + bj * HALF) = w; } }
    }
};
struct EpiProj {
    static constexpr bool PERM = true, AFTER_DRAIN = false;
    bf16_t* P; float* GB; const float* bgate; float qa_scale, qb_scale;
    __device__ __forceinline__ void operator()(const f32x4 (&acc)[2][2][4][2], const Unit& u, int wr, int wc, int fr, int fq) const {
        const int row0 = u.pm * BM + wr * 64 + fr, col0 = u.pn * BM + wc * 32 + 8 * fq;
        if (u.pn < 9) {
            const float sc = (u.pn < 2) ? qa_scale : ((u.pn == 3) ? qb_scale : 1.0f);
#pragma unroll
            for (int ai = 0; ai < 2; ++ai)
#pragma unroll
                for (int m = 0; m < 4; ++m) { bf16_t* rowp = P + (size_t)(row0 + ai * HALF + m * 16) * 2560 + col0;
#pragma unroll
                    for (int bj = 0; bj < 2; ++bj) { const f32x4 v0 = acc[ai][bj][m][0] * sc, v1 = acc[ai][bj][m][1] * sc;
                        u32x4 w; w.x = cvt_pk_bf16(v0[0], v0[1]); w.y = cvt_pk_bf16(v0[2], v0[3]); w.z = cvt_pk_bf16(v1[0], v1[1]); w.w = cvt_pk_bf16(v1[2], v1[3]);
                        *(u32x4*)(rowp + bj * HALF) = w; } }
        } else {
            const int g0 = wc * 32 + 8 * fq;
            f32x4 bv[2][2];
#pragma unroll
            for (int bj = 0; bj < 2; ++bj)
#pragma unroll
                for (int n = 0; n < 2; ++n) bv[bj][n] = *(const f32x4*)(bgate + g0 + bj * HALF + 4 * n);
#pragma unroll
            for (int ai = 0; ai < 2; ++ai)
#pragma unroll
                for (int m = 0; m < 4; ++m) { float* rowp = GB + (size_t)(row0 + ai * HALF + m * 16) * 256 + g0;
#pragma unroll
                    for (int bj = 0; bj < 2; ++bj)
#pragma unroll
                        for (int n = 0; n < 2; ++n) { const f32x4 v = acc[ai][bj][m][n] + bv[bj][n]; f32x4 o;
#pragma unroll
                            for (int i = 0; i < 4; ++i) { const float x = v[i]; o[i] = (fminf(x, 0.f) - __logf(1.0f + __expf(-fabsf(x)))) * 0.0625f; }
                            *(f32x4*)(rowp + bj * HALF + 4 * n) = o; } }
        }
    }
};
template <int CTRL> __device__ __forceinline__ float dppf(float old, float src) {
    return __builtin_bit_cast(float, __builtin_amdgcn_update_dpp(__builtin_bit_cast(int, old), __builtin_bit_cast(int, src), CTRL, 0xf, 0xf, false));
}
__device__ __forceinline__ float gelu_tanh(float x) {
    const float t = x * (1.0f + 0.044715f * x * x);
    const float e = __builtin_amdgcn_exp2f(-2.3022082f * t);
    return x * __builtin_amdgcn_rcpf(1.0f + e);
}
struct EpiFfnUp {
    static constexpr bool PERM = true, AFTER_DRAIN = false;
    bf16_t* ACT;
    bf16_t* USIDE;
    const float* cw;
    const float* cb;
    const float* past;
    float* ffn_p;
    float* ffn_s;
    __device__ __forceinline__ void operator()(const f32x4 (&acc)[2][2][4][2], const Unit& u, int wr, int wc, int fr, int fq) const {
        const int chb = u.pn * 128 + wc * 32 + 8 * fq;
        const bool smp = u.pm >= 64; const int tok = fr & 3;
#pragma unroll
        for (int n = 0; n < 2; ++n) {
            f32x4 w0[2], w1[2], w2[2], bb[2];
#pragma unroll
            for (int bj = 0; bj < 2; ++bj) { const int col = bj * 2816 + chb + 4 * n;
                w0[bj] = *(const f32x4*)(cw + col); w1[bj] = *(const f32x4*)(cw + 5632 + col); w2[bj] = *(const f32x4*)(cw + 2 * 5632 + col); bb[bj] = *(const f32x4*)(cb + col); }
#pragma unroll
            for (int ai = 0; ai < 2; ++ai) {
                const int grp = u.pm * 4 + ai * 2 + wr;
#pragma unroll
                for (int m = 0; m < 4; ++m) {
                    const int row = u.pm * BM + ai * HALF + wr * 64 + m * 16 + fr;
                    f32x4 uc[2];
                    if (!smp) {
#pragma unroll
                        for (int bj = 0; bj < 2; ++bj) { const f32x4 cur = acc[ai][bj][m][n]; const f32x4 pb = acc[ai][bj][m > 0 ? m - 1 : 0][n]; f32x4 r;
#pragma unroll
                            for (int i = 0; i < 4; ++i) { const float x1 = dppf<0x111>(dppf<0x121>(0.f, pb[i]), cur[i]); const float x2 = dppf<0x112>(dppf<0x122>(0.f, pb[i]), cur[i]);
                                r[i] = w0[bj][i] * x2 + w1[bj][i] * x1 + w2[bj][i] * cur[i] + bb[bj][i]; }
                            uc[bj] = r;
                            const int col = bj * 2816 + chb + 4 * n;
                            if (m == 0 && fr < 2) { u32x2 w; w.x = cvt_pk_bf16(cur[0], cur[1]); w.y = cvt_pk_bf16(cur[2], cur[3]); *(u32x2*)(USIDE + ((size_t)grp * 4 + 2 + fr) * 5632 + col) = w; }
                            if (m == 3 && fr >= 14) { u32x2 w; w.x = cvt_pk_bf16(cur[0], cur[1]); w.y = cvt_pk_bf16(cur[2], cur[3]); *(u32x2*)(USIDE + ((size_t)grp * 4 + (fr - 14)) * 5632 + col) = w;
                                if ((u.pm & 15) == 15 && ai == 1 && wr == 1) *(f32x4*)(ffn_p + ((size_t)(u.pm >> 4) * 2 + (fr - 14)) * 5632 + col) = cur; }
                        }
                    } else {
                        const int seq = (row - 16384) >> 2;
#pragma unroll
                        for (int bj = 0; bj < 2; ++bj) { const f32x4 cur = acc[ai][bj][m][n]; const int col = bj * 2816 + chb + 4 * n;
                            const f32x4 p0 = *(const f32x4*)(past + ((size_t)seq * 2 + 0) * 5632 + col), p1 = *(const f32x4*)(past + ((size_t)seq * 2 + 1) * 5632 + col); f32x4 r;
#pragma unroll
                            for (int i = 0; i < 4; ++i) { const float c1 = dppf<0x111>(0.f, cur[i]), c2 = dppf<0x112>(0.f, cur[i]);
                                const float x1 = (tok == 0) ? p1[i] : c1; const float x2 = (tok == 0) ? p0[i] : ((tok == 1) ? p1[i] : c2);
                                r[i] = w0[bj][i] * x2 + w1[bj][i] * x1 + w2[bj][i] * cur[i] + bb[bj][i]; }
                            uc[bj] = r;
                            if (tok >= 2) *(f32x4*)(ffn_s + ((size_t)seq * 2 + (tok - 2)) * 5632 + col) = cur;
                        }
                    }
                    if (smp || m > 0 || fr >= 2) {
                        u32x2 w; w.x = cvt_pk_bf16(gelu_tanh(uc[0][0]) * uc[1][0], gelu_tanh(uc[0][1]) * uc[1][1]); w.y = cvt_pk_bf16(gelu_tanh(uc[0][2]) * uc[1][2], gelu_tanh(uc[0][3]) * uc[1][3]);
                        *(u32x2*)(ACT + (size_t)row * 2816 + chb + 4 * n) = w;
                    }
                }
            }
            asm volatile("" ::: "memory");
        }
    }
};
template <class Epi, class Sched, bool ALIGN_EPI = false, bool SP2 = false>
__device__ __forceinline__ void gemm_phase(PG8_LAS unsigned char* lds, const Gemm g, const Sched& S, const Epi& E) {
    const int tid = threadIdx.x, wid = __builtin_amdgcn_readfirstlane(tid >> 6), lane = tid & 63, wr = wid >> 2, wc = wid & 3, fr = lane & 15, fq = lane >> 4;
    const int K = g.K, nt = K / BK;
    unsigned voffA[2], voffB[2];
#pragma unroll
    for (int i = 0; i < 2; ++i) { int R, C; stage_rc(tid * 16 + i * 8192, R, C); const int Rb = Epi::PERM ? ((R & ~31) + perm32(R & 31)) : R;
        voffA[i] = (unsigned)(R * K + C) * 2u; voffB[i] = (unsigned)(Rb * K + C) * 2u; }
    const size_t kstep = (size_t)(BK * 2);
    const size_t hstep = (size_t)HALF * K * 2;
    const size_t tstep = 2 * hstep;
    const unsigned ldsw = (unsigned)wid * 1024u;
    const int aoff = lds_byte(wr * 64 + fr, fq * 8), boff = lds_byte(wc * 32 + fr, fq * 8);
#define PG8_SA(b, h) (((b) * 2 + (h)) * HTB)
#define PG8_SB(b, h) ((4 + (b) * 2 + (h)) * HTB)
#define PG8_STAGE(bufoff, gbase, voff) do { _Pragma("unroll") for (int _i = 0; _i < 2; ++_i) \
        __builtin_amdgcn_global_load_lds((const unsigned*)((const char*)(gbase) + (voff)[_i]), (PG8_LAS unsigned*)(lds + (bufoff) + ldsw + _i * 8192), 16, 0, 0); } while (0)
#define PG8_LDA(dst, b, h) do { _Pragma("unroll") for (int m = 0; m < 4; ++m) _Pragma("unroll") for (int k = 0; k < 2; ++k) dst[m][k] = *(const PG8_LAS bf16x8*)(lds + PG8_SA(b, h) + aoff + m * 2048 + k * 1024); } while (0)
#define PG8_LDB(dst, b, h) do { _Pragma("unroll") for (int n = 0; n < 2; ++n) _Pragma("unroll") for (int k = 0; k < 2; ++k) dst[n][k] = *(const PG8_LAS bf16x8*)(lds + PG8_SB(b, h) + boff + n * 2048 + k * 1024); } while (0)
#define PG8_MMA(ai, bj, At, Bt) do { __builtin_amdgcn_s_setprio(1); _Pragma("unroll") for (int m = 0; m < 4; ++m) _Pragma("unroll") for (int n = 0; n < 2; ++n) _Pragma("unroll") for (int k = 0; k < 2; ++k) \
        acc[ai][bj][m][n] = __builtin_amdgcn_mfma_f32_16x16x32_bf16(Bt[n][k], At[m][k], acc[ai][bj][m][n], 0, 0, 0); __builtin_amdgcn_s_setprio(0); } while (0)
#define PG8_WAIT_V(n) asm volatile("s_waitcnt vmcnt(" #n ")" ::: "memory")
#define PG8_WAIT_L(n) asm volatile("s_waitcnt lgkmcnt(" #n ")" ::: "memory")
#define PG8_BAR __builtin_amdgcn_s_barrier()
#define PG8_SCHED __builtin_amdgcn_sched_barrier(0)
    Unit cur, nxt; int ui = 0;
    if (!S.next(0, cur)) return;
    f32x4 acc[2][2][4][2];
#pragma unroll
    for (int a = 0; a < 2; ++a)
#pragma unroll
        for (int b = 0; b < 2; ++b)
#pragma unroll
            for (int m = 0; m < 4; ++m)
#pragma unroll
                for (int n = 0; n < 2; ++n) acc[a][b][m][n] = (f32x4){0.f, 0.f, 0.f, 0.f};
    bf16x8 At[4][2], B0[2][2], B1[2][2];
    const char* cA = (const char*)g.A + (size_t)cur.pm * tstep; const char* cB = (const char*)g.Bt + (size_t)cur.pn * tstep;
    S.a_ready(cur);
    if constexpr (SP2) {
        PG8_STAGE(PG8_SB(0, 0), cB, voffB); PG8_STAGE(PG8_SB(0, 1), cB + hstep, voffB); PG8_STAGE(PG8_SA(0, 0), cA, voffA); PG8_STAGE(PG8_SA(0, 1), cA + hstep, voffA);
        if (wr == 1) PG8_BAR;
        PG8_WAIT_V(2); PG8_BAR;
        PG8_STAGE(PG8_SB(1, 0), cB + kstep, voffB); PG8_STAGE(PG8_SA(1, 0), cA + kstep, voffA); PG8_STAGE(PG8_SB(1, 1), cB + hstep + kstep, voffB);
        PG8_WAIT_V(6); PG8_BAR;
    } else {
        PG8_STAGE(PG8_SB(0, 0), cB, voffB); PG8_STAGE(PG8_SA(0, 0), cA, voffA); PG8_STAGE(PG8_SB(0, 1), cB + hstep, voffB); PG8_STAGE(PG8_SA(0, 1), cA + hstep, voffA);
        if (wr == 1) PG8_BAR;
        PG8_WAIT_V(4); PG8_BAR;
        PG8_STAGE(PG8_SB(1, 0), cB + kstep, voffB); PG8_STAGE(PG8_SA(1, 0), cA + kstep, voffA); PG8_STAGE(PG8_SB(1, 1), cB + hstep + kstep, voffB);
        PG8_WAIT_V(6); PG8_BAR;
    }
    for (;;) {
        const bool has_next = S.next(ui + 1, nxt);
        const char* nA = has_next ? (const char*)g.A + (size_t)nxt.pm * tstep : cA; const char* nB = has_next ? (const char*)g.Bt + (size_t)nxt.pn * tstep : cB;
        for (int t = 0; t < nt; t += 2) {
            const bool last = (t == nt - 2);
            const char* a1 = cA + (size_t)(t + 1) * kstep;
            const char* a2 = last ? nA : cA + (size_t)(t + 2) * kstep; const char* b2 = last ? nB : cB + (size_t)(t + 2) * kstep;
            const char* a3 = a2 + kstep; const char* b3 = b2 + kstep;
            if (last && has_next) S.a_ready(nxt);
            if constexpr (SP2) {
            PG8_LDB(B0, 0, 0); PG8_LDB(B1, 0, 1); PG8_SCHED; PG8_LDA(At, 0, 0); PG8_STAGE(PG8_SA(1, 1), a1 + hstep, voffA);
            PG8_WAIT_V(8); PG8_WAIT_L(0); PG8_BAR; PG8_MMA(0, 0, At, B0); PG8_MMA(0, 1, At, B1); PG8_BAR; PG8_SCHED;
            PG8_LDA(At, 0, 1); PG8_STAGE(PG8_SB(0, 0), b2, voffB); PG8_STAGE(PG8_SB(0, 1), b2 + hstep, voffB); PG8_STAGE(PG8_SA(0, 0), a2, voffA);
            PG8_WAIT_V(8); PG8_WAIT_L(0); PG8_BAR; PG8_MMA(1, 0, At, B0); PG8_MMA(1, 1, At, B1); PG8_BAR; PG8_SCHED;
            PG8_LDB(B0, 1, 0); PG8_LDB(B1, 1, 1); PG8_SCHED; PG8_LDA(At, 1, 0); PG8_STAGE(PG8_SA(0, 1), a2 + hstep, voffA);
            PG8_WAIT_V(8); PG8_WAIT_L(0); PG8_BAR; PG8_MMA(0, 0, At, B0); PG8_MMA(0, 1, At, B1); PG8_BAR; PG8_SCHED;
            PG8_LDA(At, 1, 1); PG8_STAGE(PG8_SB(1, 0), b3, voffB); PG8_STAGE(PG8_SB(1, 1), b3 + hstep, voffB); PG8_STAGE(PG8_SA(1, 0), a3, voffA);
            PG8_WAIT_V(8); PG8_WAIT_L(0); PG8_BAR; PG8_MMA(1, 0, At, B0); PG8_MMA(1, 1, At, B1); PG8_BAR; PG8_SCHED;
            } else {
            PG8_LDB(B0, 0, 0); PG8_SCHED; PG8_LDA(At, 0, 0); PG8_STAGE(PG8_SA(1, 1), a1 + hstep, voffA);
            PG8_WAIT_L(8); PG8_BAR; PG8_WAIT_L(0); PG8_MMA(0, 0, At, B0); PG8_BAR; PG8_SCHED;
            PG8_LDB(B1, 0, 1); PG8_STAGE(PG8_SB(0, 0), b2, voffB);
            PG8_BAR; PG8_WAIT_L(0); PG8_MMA(0, 1, At, B1); PG8_BAR;
            PG8_LDA(At, 0, 1); PG8_STAGE(PG8_SA(0, 0), a2, voffA);
            PG8_BAR; PG8_WAIT_L(0); PG8_MMA(1, 0, At, B0); PG8_BAR; PG8_SCHED;
            PG8_STAGE(PG8_SB(0, 1), b2 + hstep, voffB);
            PG8_WAIT_V(6); PG8_BAR; PG8_MMA(1, 1, At, B1); PG8_BAR;
            PG8_LDB(B0, 1, 0); PG8_SCHED; PG8_LDA(At, 1, 0); PG8_STAGE(PG8_SA(0, 1), a2 + hstep, voffA);
            PG8_WAIT_L(8); PG8_BAR; PG8_WAIT_L(0); PG8_MMA(0, 0, At, B0); PG8_BAR; PG8_SCHED;
            PG8_LDB(B1, 1, 1); PG8_STAGE(PG8_SB(1, 0), b3, voffB);
            PG8_BAR; PG8_WAIT_L(0); PG8_MMA(0, 1, At, B1); PG8_BAR;
            PG8_LDA(At, 1, 1); PG8_STAGE(PG8_SA(1, 0), a3, voffA);
            PG8_BAR; PG8_WAIT_L(0); PG8_MMA(1, 0, At, B0); PG8_BAR; PG8_SCHED;
            PG8_STAGE(PG8_SB(1, 1), b3 + hstep, voffB);
            PG8_WAIT_V(6); PG8_BAR; PG8_MMA(1, 1, At, B1); PG8_BAR;
            }
        }
        if constexpr (ALIGN_EPI) { if (wr == 0) PG8_BAR; }
        if constexpr (!Epi::AFTER_DRAIN) { E(acc, cur, wr, wc, fr, fq); S.done(cur); }
        if (!has_next) break;
#pragma unroll
        for (int a = 0; a < 2; ++a)
#pragma unroll
            for (int b = 0; b < 2; ++b)
#pragma unroll
                for (int m = 0; m < 4; ++m)
#pragma unroll
                    for (int n = 0; n < 2; ++n) acc[a][b][m][n] = (f32x4){0.f, 0.f, 0.f, 0.f};
        cur = nxt; cA = nA; cB = nB; ++ui;
        if constexpr (ALIGN_EPI) { if (wr == 1) PG8_BAR; }
    }
    PG8_WAIT_V(0);
    if constexpr (!ALIGN_EPI) { if (wr == 0) PG8_BAR; }
    PG8_BAR;
    if constexpr (Epi::AFTER_DRAIN) { E.fused(acc, cur, wr, wc, fr, fq, lds, wid, lane); S.done(cur); }
#undef PG8_SA
#undef PG8_SB
#undef PG8_STAGE
#undef PG8_LDA
#undef PG8_LDB
#undef PG8_MMA
#undef PG8_WAIT_V
#undef PG8_WAIT_L
#undef PG8_BAR
#undef PG8_SCHED
}
}
#define GAS __attribute__((address_space(1)))
#define LAS __attribute__((address_space(3)))
typedef unsigned short bf16;
typedef unsigned v4u __attribute__((ext_vector_type(4)));
typedef float f32x4 __attribute__((ext_vector_type(4)));
typedef short bf16x8 __attribute__((ext_vector_type(8)));
typedef GAS unsigned gu32;
typedef GAS unsigned long long gu64;
#define RLX_AGENT __ATOMIC_RELAXED, __HIP_MEMORY_SCOPE_AGENT
#define LDS_WAIT() asm volatile("s_waitcnt lgkmcnt(0)" ::: "memory")
#define VM_WAIT() asm volatile("s_waitcnt vmcnt(0)" ::: "memory")
__device__ __forceinline__ unsigned long long rt() { return __builtin_amdgcn_s_memrealtime(); }
__device__ __forceinline__ unsigned f2bf(float f) { unsigned u = __builtin_bit_cast(unsigned, f); return (u + 0x7fffu + ((u >> 16) & 1u)) >> 16; }
__device__ __forceinline__ unsigned pk2(float lo, float hi) { return f2bf(lo) | (f2bf(hi) << 16); }

#define XB_TMO      128
#define XB_XCNT(j)  (256  + 64 * (j))
#define XB_XSUB(j)  (1280 + 64 * (j))
#define XB_XGEN(j)  (2304 + 64 * (j))
#define XB_TOP      3328
#define XB_TOPGEN   3392
#define XCD_BAR_WORDS 3456
#define XB_SPIN_CAP (1u << 18)

__device__ __forceinline__ unsigned xb_ld(unsigned* p)              { return __hip_atomic_load(p, __ATOMIC_RELAXED, __HIP_MEMORY_SCOPE_AGENT); }
__device__ __forceinline__ unsigned xb_add(unsigned* p, unsigned v) { return __hip_atomic_fetch_add(p, v, __ATOMIC_RELAXED, __HIP_MEMORY_SCOPE_AGENT); }
__device__ __forceinline__ unsigned xb_xcc_id() { return (unsigned)__builtin_amdgcn_s_getreg((3 << 11) | 20) & 0xFu; }
#define XB_SPIN(cond, bar) do { unsigned _sp = 0; while (cond) { __builtin_amdgcn_s_sleep(1); \
    if ((++_sp & 255u) == 0u) { if (xb_ld(&(bar)[XB_TMO])) break; if (_sp > XB_SPIN_CAP) { atomicAdd(&(bar)[XB_TMO], 1u); break; } } } } while (0)

struct XcdBarrier {
    unsigned* bar; unsigned x;
    volatile LAS unsigned* st;
};

__device__ __forceinline__ XcdBarrier xcd_barrier_post(unsigned* bar, volatile LAS unsigned* st) {
    XcdBarrier b; b.bar = bar; b.x = xb_xcc_id(); b.st = st;
    if (threadIdx.x == 0) (void)xb_add(&bar[XB_XCNT(b.x)], 1u);
    return b;
}
__device__ __forceinline__ void xcd_barrier_complete(unsigned* bar, unsigned x, unsigned& nloc, unsigned& nx) {
    const unsigned G = gridDim.x * gridDim.y * gridDim.z;
    unsigned sum, cnt, mine, sp = 0u;
    for (;;) {
        sum = 0u; cnt = 0u; mine = 0u;
#pragma unroll
        for (unsigned j = 0; j < 16; ++j) { const unsigned c = xb_ld(&bar[XB_XCNT(j)]); sum += c; cnt += (c > 0u) ? 1u : 0u; mine = (j == x) ? c : mine; }
        if (sum == G) break;
        __builtin_amdgcn_s_sleep(1);
        if ((++sp & 255u) == 0u) { if (xb_ld(&bar[XB_TMO])) break; if (sp > XB_SPIN_CAP) { atomicAdd(&bar[XB_TMO], 1u); break; } }
    }
    nloc = mine > 0u ? mine : 1u; nx = cnt > 0u ? cnt : 1u;
}

__device__ __forceinline__ void xcd_barrier(const XcdBarrier& b) {
    asm volatile("s_waitcnt vmcnt(0)" ::: "memory");
    __syncthreads();
    if (threadIdx.x == 0) {
        unsigned* bar = b.bar;
        __builtin_amdgcn_s_waitcnt(0);
        unsigned nloc = b.st[0], nx = b.st[1];
        if (nloc == 0u) { xcd_barrier_complete(bar, b.x, nloc, nx); b.st[0] = nloc; b.st[1] = nx; }
        const unsigned old = xb_add(&bar[XB_XSUB(b.x)], 1u);
        const unsigned gen = old / nloc;
        if (old + 1u == (gen + 1u) * nloc) {
            __builtin_amdgcn_fence(__ATOMIC_RELEASE, "agent");
            asm volatile("s_waitcnt vmcnt(0)" ::: "memory");
            const unsigned og = xb_add(&bar[XB_TOP], 1u);
            const unsigned tg = og / nx;
            if (og + 1u == (tg + 1u) * nx) xb_add(&bar[XB_TOPGEN], 1u);
            else XB_SPIN(xb_ld(&bar[XB_TOPGEN]) == tg, bar);
            __builtin_amdgcn_fence(__ATOMIC_ACQUIRE, "agent");
            xb_add(&bar[XB_XGEN(b.x)], 1u);
            asm volatile("s_waitcnt vmcnt(0)" ::: "memory");
        } else {
            XB_SPIN(xb_ld(&bar[XB_XGEN(b.x)]) == gen, bar);
            __builtin_amdgcn_fence(__ATOMIC_ACQUIRE, "agent");
            asm volatile("s_waitcnt vmcnt(0)" ::: "memory");
        }
    }
    __syncthreads();
}

constexpr int NWAVES = 8;
constexpr int MP = 16384, MS = 512, M = MP + MS;
constexpr int D = 1024, SEQ = 4096, F2 = 5632, FF = 2816, NPROJ = 2560;
constexpr float EPS = 1e-6f, LOG2E = 1.4426950408889634f;
constexpr float QA_SCALE = 0.125f * LOG2E, QB_SCALE = 0.125f;
constexpr int C_QA = 0, C_KA = 512, C_VA = 640, C_QB = 768, C_KB = 1024, C_VB = 1280, C_RB = 1792;
constexpr size_t O_Y = 0, O_KP = 17301504, O_VP = 17367040, O_GP = 17432576, O_CP = 17563648, O_FP = 17571840, O_KS = 17661952, O_VS = 19759104, O_GS = 21856256, O_CS = 26050560, O_FS = 26312704, O_END = 29196288;
constexpr size_t MiB = 1u << 20;
constexpr size_t WS_CTL = 0, CTL_ZERO_BYTES = 1 * MiB;
constexpr size_t WS_W1 = 1 * MiB;
constexpr size_t WS_WOE = WS_W1 + (size_t)2560 * 1024 * 2;
constexpr size_t WS_WIO = WS_WOE + (size_t)1024 * 1024 * 2;
constexpr size_t WS_WOO = WS_WIO + (size_t)3072 * 1024 * 2;
constexpr size_t WS_WUP = WS_WOO + (size_t)1024 * 1024 * 2;
constexpr size_t WS_WDN = WS_WUP + (size_t)2 * 5632 * 1024 * 2;
constexpr size_t WS_XN = 49 * MiB;
static_assert(WS_WDN + (size_t)2 * 1024 * 2816 * 2 <= WS_XN, "weights");
constexpr size_t WS_BIG = 82 * MiB;
constexpr size_t WS_GB = WS_BIG + (size_t)M * NPROJ * 2;
constexpr size_t WS_MIX = 181 * MiB;
constexpr size_t WS_MO = 214 * MiB;
constexpr size_t WS_DC = 247 * MiB;
constexpr size_t WS_END = 248 * MiB;
static_assert(WS_GB + (size_t)M * 256 * 4 <= WS_MIX && WS_BIG + (size_t)M * 3072 * 2 <= WS_MIX && WS_MIX + (size_t)M * D * 2 <= WS_MO && WS_MO + (size_t)M * D * 2 <= WS_DC, "d_ws map");
constexpr int CW_BAR = 4096;
constexpr int RING_BYTES = 131072, LDSCTL_OFF = RING_BYTES, MISC_OFF = LDSCTL_OFF + 320, LDS_BYTES = 147456;

typedef float f32x16 __attribute__((ext_vector_type(16)));
typedef short s16x4 __attribute__((ext_vector_type(4)));
typedef float f32x2 __attribute__((ext_vector_type(2)));
typedef unsigned u32x2 __attribute__((ext_vector_type(2)));

struct Args { const float* in[24]; float* out; unsigned char* ws; };
typedef const __attribute__((address_space(4))) Args* KArgs;
__device__ __forceinline__ KArgs fresh_kargs() { KArgs p = (KArgs)__builtin_amdgcn_kernarg_segment_ptr(); asm volatile("" : "+s"(p)); return p; }
struct Frame {
    LAS unsigned char* lds;
    volatile LAS unsigned* MISC;
    gu32* ctl;
    int tid, lane, wave, vcu, G;
    KArgs ka;
};
__device__ __forceinline__ float bf2f(unsigned short b) { return __builtin_bit_cast(float, (unsigned)b << 16); }
__device__ __forceinline__ float bflo(unsigned w) { return __builtin_bit_cast(float, w << 16); }
__device__ __forceinline__ float bfhi(unsigned w) { return __builtin_bit_cast(float, w & 0xffff0000u); }
__device__ __forceinline__ float wave_sum(float v) {
#pragma unroll
    for (int o = 1; o < 64; o <<= 1) v += __shfl_xor(v, o);
    return v;
}
__device__ __forceinline__ int crow(int r, int hi) { return (r & 3) + 8 * (r >> 2) + 4 * hi; }
__device__ __forceinline__ bf16x8 pack8(const float* p) { v4u w; w.x = pk2(p[0], p[1]); w.y = pk2(p[2], p[3]); w.z = pk2(p[4], p[5]); w.w = pk2(p[6], p[7]); return __builtin_bit_cast(bf16x8, w); }
__device__ __forceinline__ s16x4 vtr(const LAS unsigned char* p) { typedef short v4i16_t __attribute__((ext_vector_type(4))); return __builtin_bit_cast(s16x4, __builtin_amdgcn_ds_read_tr16_b64_v4i16((LAS v4i16_t*)p)); }
__device__ __forceinline__ bf16x8 cat8(s16x4 lo, s16x4 hi) { return (bf16x8){lo[0], lo[1], lo[2], lo[3], hi[0], hi[1], hi[2], hi[3]}; }

__device__ __forceinline__ void tr_item(const float* W, int ldw, int k0, int n0, bf16* WT, int ldt, int drow0, LAS float* scr, int lane) {
#pragma unroll 8
    for (int i = 0; i < 32; ++i) { const int kk = 2 * i + (lane >> 5); scr[kk * 33 + (lane & 31)] = W[(size_t)(k0 + kk) * ldw + n0 + (lane & 31)]; }
    LDS_WAIT(); asm volatile("" ::: "memory");
    const int c = lane & 7;
#pragma unroll
    for (int j = 0; j < 4; ++j) { const int n = (lane >> 3) + 8 * j; const LAS float* s = scr + (8 * c) * 33 + n;
        v4u o; o.x = pk2(s[0 * 33], s[1 * 33]); o.y = pk2(s[2 * 33], s[3 * 33]); o.z = pk2(s[4 * 33], s[5 * 33]); o.w = pk2(s[6 * 33], s[7 * 33]);
        *(GAS v4u*)(WT + (size_t)(drow0 + n) * ldt + k0 + 8 * c) = o; }
    LDS_WAIT(); asm volatile("" ::: "memory");
}
__device__ __forceinline__ void rms_row_to_bf16(const float* xrow, const float* g, bf16* orow, int lane) {
    const GAS f32x4* xr = (const GAS f32x4*)xrow + lane; const GAS f32x4* gr = (const GAS f32x4*)g + lane;
    f32x4 v[4]; float s = 0.f;
#pragma unroll
    for (int j = 0; j < 4; ++j) { v[j] = xr[64 * j]; s += (v[j].x * v[j].x + v[j].y * v[j].y) + (v[j].z * v[j].z + v[j].w * v[j].w); }
    const float rs = 1.0f / sqrtf(wave_sum(s) * (1.f / D) + EPS);
    GAS unsigned long long* o8 = (GAS unsigned long long*)orow + lane;
#pragma unroll
    for (int j = 0; j < 4; ++j) { const f32x4 gg = gr[64 * j]; o8[64 * j] = (unsigned long long)pk2(v[j].x * rs * gg.x, v[j].y * rs * gg.y) | ((unsigned long long)pk2(v[j].z * rs * gg.z, v[j].w * rs * gg.w) << 32); }
}
__device__ __forceinline__ const float* xrow_in(const Frame& F, int m) { return m < MP ? F.ka->in[0] + (size_t)m * D : F.ka->in[1] + (size_t)(m - MP) * D; }

__device__ __forceinline__ void p0_prologue(Frame& F) {
    LAS float* scr = (LAS float*)(F.lds + F.wave * 16384);
    const int gw = F.vcu * NWAVES + F.wave, NGW = F.G * NWAVES;
    bf16* W1 = (bf16*)(F.ka->ws + WS_W1); bf16* WOE = (bf16*)(F.ka->ws + WS_WOE); bf16* WIO = (bf16*)(F.ka->ws + WS_WIO); bf16* WOO = (bf16*)(F.ka->ws + WS_WOO); bf16* WUP = (bf16*)(F.ka->ws + WS_WUP); bf16* WDN = (bf16*)(F.ka->ws + WS_WDN);
    constexpr int I_1 = 16 * 72, I_OE = 16 * 32, I_IO = 16 * 96, I_OO = 16 * 32, I_UP = 16 * 176, I_DN = 44 * 32;
    constexpr int NITEMS = I_1 + I_OE + I_IO + I_OO + 2 * I_UP + 2 * I_DN;
    for (int it = gw; it < NITEMS; it += NGW) {
        int r = it;
        if (r < I_1) { const int kb = r / 72, nb = r % 72; tr_item(F.ka->in[11], 2320, 64 * kb, 32 * nb, W1, 1024, 32 * nb, scr, F.lane); continue; } r -= I_1;
        if (r < I_OE) { const int kb = r / 32, nb = r % 32; tr_item(F.ka->in[16], 1024, 64 * kb, 32 * nb, WOE, 1024, 32 * nb, scr, F.lane); continue; } r -= I_OE;
        if (r < I_IO) { const int kb = r / 96, nb = r % 96; tr_item(F.ka->in[17], 3072, 64 * kb, 32 * nb, WIO, 1024, 32 * nb, scr, F.lane); continue; } r -= I_IO;
        if (r < I_OO) { const int kb = r / 32, nb = r % 32; tr_item(F.ka->in[19], 1024, 64 * kb, 32 * nb, WOO, 1024, 32 * nb, scr, F.lane); continue; } r -= I_OO;
        if (r < 2 * I_UP) { const int l = r / I_UP, q = r % I_UP, kb = q / 176, nb = q % 176; const int c = 32 * nb, half = c / FF, ch = c % FF;
            tr_item(F.ka->in[20] + (size_t)l * D * F2, F2, 64 * kb, c, WUP + (size_t)l * F2 * D, 1024, 256 * (ch / 128) + 128 * half + (ch % 128), scr, F.lane); continue; } r -= 2 * I_UP;
        { const int l = r / I_DN, q = r % I_DN, kb = q / 32, nb = q % 32;
            tr_item(F.ka->in[23] + (size_t)l * FF * D, 1024, 64 * kb, 32 * nb, WDN + (size_t)l * D * FF, FF, 32 * nb, scr, F.lane); }
    }
    {
        const int gt = F.vcu * (NWAVES * 64) + F.tid, NT = F.G * NWAVES * 64;
        for (int it = gt; it < 256 * 128; it += NT) {
            const int j = it & 255, k8 = it >> 8;
            float wg[16];
#pragma unroll
            for (int r = 0; r < 16; ++r) wg[r] = F.ka->in[12][r * 256 + j];
            float o[8];
#pragma unroll
            for (int kk = 0; kk < 8; ++kk) { const float* wr_ = F.ka->in[11] + (size_t)(8 * k8 + kk) * 2320 + 2304; float s = 0.f;
#pragma unroll
                for (int r4 = 0; r4 < 4; ++r4) { const f32x4 w = *(const GAS f32x4*)(wr_ + 4 * r4); s += w.x * wg[4 * r4] + w.y * wg[4 * r4 + 1] + w.z * wg[4 * r4 + 2] + w.w * wg[4 * r4 + 3]; }
                o[kk] = s; }
            v4u w; w.x = pk2(o[0], o[1]); w.y = pk2(o[2], o[3]); w.z = pk2(o[4], o[5]); w.w = pk2(o[6], o[7]);
            *(GAS v4u*)(W1 + (size_t)(2304 + j) * 1024 + 8 * k8) = w;
        }
        for (int it = gt; it < 2 * 128 * 124 * 32; it += NT) {
            const int which = it / (128 * 124 * 32), r = it % (128 * 124 * 32), s = r / (124 * 32), q = r % (124 * 32);
            const float* src = which ? F.ka->in[3] : F.ka->in[2];
            const f32x4 v = *(const GAS f32x4*)(src + (size_t)s * 16384 + 512 + 4 * q);
            *(GAS f32x4*)(F.ka->out + (which ? O_VS : O_KS) + (size_t)s * 16384 + 4 * q) = v;
        }
    }
    bf16* XN = (bf16*)(F.ka->ws + WS_XN);
    for (int m = gw; m < M; m += NGW) rms_row_to_bf16(xrow_in(F, m), F.ka->in[7], XN + (size_t)m * D, F.lane);
}

template <bool FIRST, bool LAST>
__device__ __forceinline__ void rowwise_phase(Frame& F, const float* gpost, const float* gpre) {
    const int gw = F.vcu * NWAVES + F.wave, NGW = F.G * NWAVES;
    const bf16* MO = (const bf16*)(F.ka->ws + WS_MO); bf16* XN = (bf16*)(F.ka->ws + WS_XN);
    for (int m = gw; m < M; m += NGW) {
        const float* base = FIRST ? xrow_in(F, m) : F.ka->out + (size_t)m * D;
        const v4u mo0 = *(const GAS v4u*)(MO + (size_t)m * D + 16 * F.lane), mo1 = *(const GAS v4u*)(MO + (size_t)m * D + 16 * F.lane + 8);
        float mv[16]; { const unsigned w[8] = {mo0.x, mo0.y, mo0.z, mo0.w, mo1.x, mo1.y, mo1.z, mo1.w};
#pragma unroll
            for (int i = 0; i < 8; ++i) { mv[2 * i] = bflo(w[i]); mv[2 * i + 1] = bfhi(w[i]); } }
        float xv[16], s = 0.f;
#pragma unroll
        for (int j = 0; j < 4; ++j) { const f32x4 t = *(const GAS f32x4*)(base + 16 * F.lane + 4 * j); xv[4 * j] = t.x; xv[4 * j + 1] = t.y; xv[4 * j + 2] = t.z; xv[4 * j + 3] = t.w; }
#pragma unroll
        for (int i = 0; i < 16; ++i) s += mv[i] * mv[i];
        const float r1 = 1.0f / sqrtf(wave_sum(s) * (1.f / D) + EPS);
        float s2 = 0.f;
#pragma unroll
        for (int j = 0; j < 4; ++j) { const f32x4 g = *(const GAS f32x4*)(gpost + 16 * F.lane + 4 * j);
            xv[4 * j] += mv[4 * j] * r1 * g.x; xv[4 * j + 1] += mv[4 * j + 1] * r1 * g.y; xv[4 * j + 2] += mv[4 * j + 2] * r1 * g.z; xv[4 * j + 3] += mv[4 * j + 3] * r1 * g.w; }
#pragma unroll
        for (int i = 0; i < 16; ++i) s2 += xv[i] * xv[i];
#pragma unroll
        for (int j = 0; j < 4; ++j) *(GAS f32x4*)(F.ka->out + (size_t)m * D + 16 * F.lane + 4 * j) = (f32x4){xv[4 * j], xv[4 * j + 1], xv[4 * j + 2], xv[4 * j + 3]};
        if (!LAST) {
            const float r2 = 1.0f / sqrtf(wave_sum(s2) * (1.f / D) + EPS);
            float o[16];
#pragma unroll
            for (int j = 0; j < 4; ++j) { const f32x4 g = *(const GAS f32x4*)(gpre + 16 * F.lane + 4 * j);
                o[4 * j] = xv[4 * j] * r2 * g.x; o[4 * j + 1] = xv[4 * j + 1] * r2 * g.y; o[4 * j + 2] = xv[4 * j + 2] * r2 * g.z; o[4 * j + 3] = xv[4 * j + 3] * r2 * g.w; }
            v4u w0, w1; w0.x = pk2(o[0], o[1]); w0.y = pk2(o[2], o[3]); w0.z = pk2(o[4], o[5]); w0.w = pk2(o[6], o[7]); w1.x = pk2(o[8], o[9]); w1.y = pk2(o[10], o[11]); w1.z = pk2(o[12], o[13]); w1.w = pk2(o[14], o[15]);
            *(GAS v4u*)(XN + (size_t)m * D + 16 * F.lane) = w0; *(GAS v4u*)(XN + (size_t)m * D + 16 * F.lane + 8) = w1;
        }
    }
}
template <bool SAMPLE>
__device__ __forceinline__ void attn_unit(Frame& F, int unit, LAS unsigned char* vt) {
    const int lane = F.lane, r32 = lane & 31, hi = lane >> 5;
    const bf16* P = (const bf16*)(F.ka->ws + WS_BIG); bf16* MIX = (bf16*)(F.ka->ws + WS_MIX);
    int head, kvh, qrow, qi, t0 = 0, rowbase = 0, seq = 0; bool qok = true;
    if (!SAMPLE) { head = unit & 7; const int qt = (unit >> 3) & 127, n = unit >> 10; kvh = head >> 2; t0 = qt * 32; rowbase = n * SEQ; qrow = rowbase + t0 + r32; qi = r32; }
    else { seq = unit >> 1; kvh = unit & 1; const int g = (r32 >> 2) & 3; qi = r32 & 3; head = kvh * 4 + g; qrow = MP + seq * 4 + qi; qok = r32 < 16; }
    const float slope2 = __builtin_amdgcn_exp2f(-(float)(head + 1)) * LOG2E, sink2 = F.ka->in[14][head] * LOG2E;
    bf16x8 qf[4];
#pragma unroll
    for (int s = 0; s < 4; ++s) qf[s] = *(const GAS bf16x8*)(P + (size_t)qrow * NPROJ + C_QA + head * 64 + 16 * s + 8 * hi);
    float mx = sink2, l = (hi == 0) ? 1.0f : 0.0f;
    f32x16 o[2]; o[0] = (f32x16){}; o[1] = (f32x16){};
    const int q4 = (lane & 15) >> 2, p4 = lane & 3, g1 = (lane >> 4) & 1;
#pragma unroll 1
    for (int kb = 0; kb < 5; ++kb) {
        f32x16 sT = (f32x16){};
        const int j = 32 * kb + r32;
#pragma unroll
        for (int s = 0; s < 4; ++s) {
            bf16x8 kf = (bf16x8){};
            if (!SAMPLE) { const int pos = t0 - 128 + j; if (pos >= 0) kf = *(const GAS bf16x8*)(P + (size_t)(rowbase + pos) * NPROJ + C_KA + kvh * 64 + 16 * s + 8 * hi); }
            else {
                if (j < 128) { const float* kp = F.ka->in[2] + ((size_t)(seq * 128 + j) * 2 + kvh) * 64 + 16 * s + 8 * hi; const f32x4 a = *(const GAS f32x4*)kp, b = *(const GAS f32x4*)(kp + 4);
                    const float t[8] = {a.x, a.y, a.z, a.w, b.x, b.y, b.z, b.w}; kf = pack8(t); }
                else if (j < 132) kf = *(const GAS bf16x8*)(P + (size_t)(MP + seq * 4 + (j - 128)) * NPROJ + C_KA + kvh * 64 + 16 * s + 8 * hi);
            }
            sT = __builtin_amdgcn_mfma_f32_32x32x16_bf16(kf, qf[s], sT, 0, 0, 0);
        }
#pragma unroll
        for (int it = 0; it < 4; ++it) { const int idx = it * 64 + lane, row = idx >> 3, ch = idx & 7, jv = 32 * kb + row; v4u v = (v4u){0u, 0u, 0u, 0u};
            if (!SAMPLE) { const int pos = t0 - 128 + jv; if (pos >= 0) v = *(const GAS v4u*)(P + (size_t)(rowbase + pos) * NPROJ + C_VA + kvh * 64 + 8 * ch); }
            else {
                if (jv < 128) { const float* vp = F.ka->in[3] + ((size_t)(seq * 128 + jv) * 2 + kvh) * 64 + 8 * ch; const f32x4 a = *(const GAS f32x4*)vp, b = *(const GAS f32x4*)(vp + 4);
                    v.x = pk2(a.x, a.y); v.y = pk2(a.z, a.w); v.z = pk2(b.x, b.y); v.w = pk2(b.z, b.w); }
                else if (jv < 132) v = *(const GAS v4u*)(P + (size_t)(MP + seq * 4 + (jv - 128)) * NPROJ + C_VA + kvh * 64 + 8 * ch);
            }
            *(LAS v4u*)(vt + row * 192 + ch * 16) = v; }
        float bm = -INFINITY;
#pragma unroll
        for (int r = 0; r < 16; ++r) { const int jj = 32 * kb + crow(r, hi); const int dist = 128 + qi - jj; bool ok = (dist >= 0) && (dist <= 128); if (!SAMPLE) ok = ok && (t0 - 128 + jj >= 0);
            const float v = ok ? sT[r] - slope2 * (float)dist : -INFINITY; sT[r] = v; bm = fmaxf(bm, v); }
        bm = fmaxf(bm, __shfl_xor(bm, 32));
        const float mn = fmaxf(mx, bm), alpha = __builtin_amdgcn_exp2f(mx - mn); mx = mn;
        float ls = 0.f;
#pragma unroll
        for (int r = 0; r < 16; ++r) { const float p = __builtin_amdgcn_exp2f(sT[r] - mn); sT[r] = p; ls += p; }
        l = l * alpha + ls;
#pragma unroll
        for (int r = 0; r < 16; ++r) { o[0][r] *= alpha; o[1][r] *= alpha; }
        LDS_WAIT(); asm volatile("" ::: "memory");
#pragma unroll
        for (int s = 0; s < 2; ++s) {
            float t[8];
#pragma unroll
            for (int e = 0; e < 8; ++e) t[e] = sT[8 * s + e];
            const bf16x8 pb = pack8(t);
#pragma unroll
            for (int db = 0; db < 2; ++db) {
                const s16x4 lo = vtr(vt + (16 * s + 4 * hi + q4) * 192 + (32 * db + 16 * g1 + 4 * p4) * 2), hh = vtr(vt + (16 * s + 8 + 4 * hi + q4) * 192 + (32 * db + 16 * g1 + 4 * p4) * 2);
                o[db] = __builtin_amdgcn_mfma_f32_32x32x16_bf16(cat8(lo, hh), pb, o[db], 0, 0, 0);
            }
        }
        LDS_WAIT(); asm volatile("" ::: "memory");
    }
    l += __shfl_xor(l, 32);
    const float inv = 1.0f / l;
    if (qok) {
#pragma unroll
        for (int db = 0; db < 2; ++db)
#pragma unroll
            for (int rg = 0; rg < 4; ++rg) { const int d0 = 32 * db + 8 * rg + 4 * hi; u32x2 w; w.x = pk2(o[db][4 * rg] * inv, o[db][4 * rg + 1] * inv); w.y = pk2(o[db][4 * rg + 2] * inv, o[db][4 * rg + 3] * inv);
                *(GAS u32x2*)(MIX + (size_t)qrow * D + head * 64 + d0) = w; }
    }
}

__device__ __forceinline__ float silu_f(float x) { return x / (1.0f + __expf(-x)); }
__device__ __forceinline__ float rdl(float v, int l) { return __builtin_bit_cast(float, __builtin_amdgcn_readlane(__builtin_bit_cast(int, v), l)); }
__device__ __forceinline__ void gla_sample_unit(Frame& F, int unit) {
    const int seq = unit >> 2, h = unit & 3, lane = F.lane;
    const bf16* P = (const bf16*)(F.ka->ws + WS_BIG); const float* GB = (const float*)(F.ka->ws + WS_GB); bf16* MIX = (bf16*)(F.ka->ws + WS_MIX);
    const float* S0 = F.ka->in[4] + (size_t)unit * 8192;
    float S[64][2];
#pragma unroll
    for (int dk = 0; dk < 64; ++dk) { const f32x2 t = *(const GAS f32x2*)(S0 + dk * 128 + 2 * lane); S[dk][0] = t.x; S[dk][1] = t.y; }
    const f32x2 gn = *(const GAS f32x2*)(F.ka->in[15] + h * 128 + 2 * lane);
    for (int t = 0; t < 4; ++t) {
        const size_t row = (size_t)(MP + seq * 4 + t);
        const float qv = bf2f(P[row * NPROJ + C_QB + h * 64 + lane]), kv = bf2f(P[row * NPROJ + C_KB + h * 64 + lane]), eg = __expf(GB[row * 256 + h * 64 + lane]);
        const unsigned vw = *(const GAS unsigned*)(P + row * NPROJ + C_VB + h * 128 + 2 * lane); const float v0 = bflo(vw), v1 = bfhi(vw);
        float o0 = 0.f, o1 = 0.f;
#pragma unroll
        for (int dk = 0; dk < 64; ++dk) { const float e = rdl(eg, dk), kk = rdl(kv, dk), qq = rdl(qv, dk);
            S[dk][0] = e * S[dk][0] + kk * v0; S[dk][1] = e * S[dk][1] + kk * v1; o0 += qq * S[dk][0]; o1 += qq * S[dk][1]; }
        const float rs = 1.0f / sqrtf(wave_sum(o0 * o0 + o1 * o1) * (1.f / 128.f) + EPS);
        const unsigned rw = *(const GAS unsigned*)(P + row * NPROJ + C_RB + h * 128 + 2 * lane);
        *(GAS unsigned*)(MIX + row * D + 512 + h * 128 + 2 * lane) = pk2(o0 * rs * gn.x * silu_f(bflo(rw)), o1 * rs * gn.y * silu_f(bfhi(rw)));
    }
    float* So = F.ka->out + O_GS + (size_t)unit * 8192;
#pragma unroll
    for (int dk = 0; dk < 64; ++dk) *(GAS f32x2*)(So + dk * 128 + 2 * lane) = (f32x2){S[dk][0], S[dk][1]};
}

constexpr int L_SEGS = 0, L_PART = 2048, L_QT = 4096, L_KT = 16384, L_VT = 28672;
__device__ __forceinline__ float gla_prefix(Frame& F, const float* GB, int r0, int h, float (&b)[8]) {
    const int dk = F.tid & 63, seg = F.tid >> 6; LAS float* segs = (LAS float*)(F.lds + L_SEGS);
    float run = 0.f;
#pragma unroll
    for (int t = 0; t < 8; ++t) { run += GB[(size_t)(r0 + 8 * seg + t) * 256 + h * 64 + dk]; b[t] = run; }
    segs[seg * 64 + dk] = run;
    __syncthreads();
    float offs = 0.f, tot = 0.f;
#pragma unroll
    for (int s = 0; s < 8; ++s) { const float v = segs[s * 64 + dk]; tot += v; offs += (s < seg) ? v : 0.f; }
#pragma unroll
    for (int t = 0; t < 8; ++t) b[t] += offs;
    return tot;
}
__device__ __forceinline__ void gla_load_v(Frame& F, const bf16* P, int r0, int h) {
#pragma unroll
    for (int it = 0; it < 2; ++it) { const int idx = it * 512 + F.tid, tok = idx >> 4, ch = idx & 15;
        *(LAS v4u*)(F.lds + L_VT + tok * 320 + ch * 16) = *(const GAS v4u*)(P + (size_t)(r0 + tok) * NPROJ + C_VB + h * 128 + 8 * ch); }
}
__device__ __forceinline__ void gla_u_unit(Frame& F, int unit) {
    const int n = unit >> 8, h = (unit >> 6) & 3, c = unit & 63, r0 = n * SEQ + 64 * c;
    const bf16* P = (const bf16*)(F.ka->ws + WS_BIG); const float* GB = (const float*)(F.ka->ws + WS_GB); float* UT = (float*)(F.ka->ws + WS_XN); float* DC = (float*)(F.ka->ws + WS_DC);
    const int dk = F.tid & 63, seg = F.tid >> 6, lane = F.lane, r32 = lane & 31, hi = lane >> 5;
    float b[8]; const float tot = gla_prefix(F, GB, r0, h, b);
    LAS bf16* KH = (LAS bf16*)(F.lds + L_KT);
#pragma unroll
    for (int t = 0; t < 8; ++t) { const int tok = 8 * seg + t; const float kv = bf2f(P[(size_t)(r0 + tok) * NPROJ + C_KB + h * 64 + dk]) * __expf(tot - b[t]); KH[tok * 96 + dk] = (bf16)f2bf(kv); }
    if (seg == 0) DC[unit * 64 + dk] = __expf(tot);
    gla_load_v(F, P, r0, h);
    __syncthreads();
    const int dvb = F.wave >> 1, dkb = F.wave & 1, q4 = (lane & 15) >> 2, p4 = lane & 3, g1 = (lane >> 4) & 1;
    f32x16 acc = (f32x16){};
#pragma unroll
    for (int s = 0; s < 4; ++s) {
        const LAS unsigned char* va = F.lds + L_VT + (16 * s + 8 * hi + q4) * 320 + (32 * dvb + 16 * g1 + 4 * p4) * 2;
        const LAS unsigned char* ka = F.lds + L_KT + (16 * s + 8 * hi + q4) * 192 + (32 * dkb + 16 * g1 + 4 * p4) * 2;
        const bf16x8 af = cat8(vtr(va), vtr(va + 4 * 320)), bfr = cat8(vtr(ka), vtr(ka + 4 * 192));
        acc = __builtin_amdgcn_mfma_f32_32x32x16_bf16(af, bfr, acc, 0, 0, 0);
    }
#pragma unroll
    for (int r = 0; r < 16; ++r) UT[((size_t)unit * 128 + 32 * dvb + crow(r, hi)) * 64 + 32 * dkb + r32] = acc[r];
    __syncthreads();
}
__device__ __forceinline__ void gla_scan_phase(Frame& F) {
    const float* UT = (const float*)(F.ka->ws + WS_XN); const float* DC = (const float*)(F.ka->ws + WS_DC); bf16* SB = (bf16*)(F.ka->ws + WS_MO);
    for (int eg = F.vcu * 512 + F.tid; eg < 16 * 8192; eg += F.G * 512) {
        const int nh = eg >> 13, e = eg & 8191, dk = e & 63, dv = e >> 6;
        float S = 0.f;
#pragma unroll 8
        for (int c = 0; c < 64; ++c) { const int unit = nh * 64 + c; SB[(size_t)unit * 8192 + e] = (bf16)f2bf(S); S = DC[unit * 64 + dk] * S + UT[(size_t)unit * 8192 + e]; }
        F.ka->out[O_GP + (size_t)nh * 8192 + dk * 128 + dv] = S;
    }
}
__device__ __forceinline__ void gla_out_unit(Frame& F, int unit) {
    const int n = unit >> 8, h = (unit >> 6) & 3, c = unit & 63, r0 = n * SEQ + 64 * c;
    const bf16* P = (const bf16*)(F.ka->ws + WS_BIG); const float* GB = (const float*)(F.ka->ws + WS_GB); const bf16* SB = (const bf16*)(F.ka->ws + WS_MO); bf16* MIX = (bf16*)(F.ka->ws + WS_MIX);
    const int dk = F.tid & 63, seg = F.tid >> 6, lane = F.lane, r32 = lane & 31, hi = lane >> 5;
    float b[8]; (void)gla_prefix(F, GB, r0, h, b);
    LAS bf16* QT = (LAS bf16*)(F.lds + L_QT); LAS bf16* KT = (LAS bf16*)(F.lds + L_KT);
#pragma unroll
    for (int t = 0; t < 8; ++t) { const int tok = 8 * seg + t; const size_t rp = (size_t)(r0 + tok) * NPROJ + h * 64 + dk;
        QT[tok * 72 + dk] = (bf16)f2bf(bf2f(P[rp + C_QB]) * __expf(b[t])); KT[tok * 72 + dk] = (bf16)f2bf(bf2f(P[rp + C_KB]) * __expf(-b[t])); }
    gla_load_v(F, P, r0, h);
    __syncthreads();
    const int tb = F.wave & 1, dvb = F.wave >> 1, q4 = (lane & 15) >> 2, p4 = lane & 3, g1 = (lane >> 4) & 1;
    bf16x8 qf[4];
#pragma unroll
    for (int s = 0; s < 4; ++s) qf[s] = *(const LAS bf16x8*)(F.lds + L_QT + (32 * tb + r32) * 144 + 32 * s + 16 * hi);
    f32x16 o = (f32x16){};
    for (int jb = 0; jb <= tb; ++jb) {
        f32x16 at = (f32x16){};
#pragma unroll
        for (int s = 0; s < 4; ++s) { const bf16x8 kf = *(const LAS bf16x8*)(F.lds + L_KT + (32 * jb + r32) * 144 + 32 * s + 16 * hi); at = __builtin_amdgcn_mfma_f32_32x32x16_bf16(kf, qf[s], at, 0, 0, 0); }
        const int icol = 32 * tb + r32;
#pragma unroll
        for (int r = 0; r < 16; ++r) { const int j = 32 * jb + crow(r, hi); if (j > icol) at[r] = 0.f; }
#pragma unroll
        for (int s = 0; s < 2; ++s) {
            float t[8];
#pragma unroll
            for (int e = 0; e < 8; ++e) t[e] = at[8 * s + e];
            const bf16x8 pb = pack8(t);
            const LAS unsigned char* va = F.lds + L_VT + (32 * jb + 16 * s + 4 * hi + q4) * 320 + (32 * dvb + 16 * g1 + 4 * p4) * 2;
            o = __builtin_amdgcn_mfma_f32_32x32x16_bf16(cat8(vtr(va), vtr(va + 8 * 320)), pb, o, 0, 0, 0);
        }
    }
#pragma unroll
    for (int s = 0; s < 4; ++s) { const bf16x8 sf = *(const GAS bf16x8*)(SB + ((size_t)unit * 128 + 32 * dvb + r32) * 64 + 16 * s + 8 * hi); o = __builtin_amdgcn_mfma_f32_32x32x16_bf16(sf, qf[s], o, 0, 0, 0); }
    float ssq = 0.f;
#pragma unroll
    for (int r = 0; r < 16; ++r) ssq += o[r] * o[r];
    ssq += __shfl_xor(ssq, 32);
    LAS float* part = (LAS float*)(F.lds + L_PART);
    if (hi == 0) part[dvb * 64 + 32 * tb + r32] = ssq;
    __syncthreads();
    const int tk = 32 * tb + r32;
    const float rs = 1.0f / sqrtf((part[tk] + part[64 + tk] + part[128 + tk] + part[192 + tk]) * (1.f / 128.f) + EPS);
    const size_t row = (size_t)(r0 + tk);
#pragma unroll
    for (int rg = 0; rg < 4; ++rg) { const int dv0 = 32 * dvb + 8 * rg + 4 * hi;
        const u32x2 rw = *(const GAS u32x2*)(P + row * NPROJ + C_RB + h * 128 + dv0); const f32x4 gn = *(const GAS f32x4*)(F.ka->in[15] + h * 128 + dv0);
        u32x2 w; w.x = pk2(o[4 * rg] * rs * gn.x * silu_f(bflo(rw.x)), o[4 * rg + 1] * rs * gn.y * silu_f(bfhi(rw.x))); w.y = pk2(o[4 * rg + 2] * rs * gn.z * silu_f(bflo(rw.y)), o[4 * rg + 3] * rs * gn.w * silu_f(bfhi(rw.y)));
        *(GAS u32x2*)(MIX + row * D + 512 + h * 128 + dv0) = w; }
    __syncthreads();
}

__device__ __forceinline__ void mixer_phase1(Frame& F) {
    const int gw = F.vcu * NWAVES + F.wave, NGW = F.G * NWAVES;
    LAS unsigned char* vt = F.lds + 65536 + F.wave * 8192;
    for (int u = gw; u < 4096; u += NGW) attn_unit<false>(F, u, vt);
    for (int u = gw; u < 256; u += NGW) attn_unit<true>(F, u, vt);
    for (int u = gw; u < 512; u += NGW) gla_sample_unit(F, u);
    {
        const bf16* P = (const bf16*)(F.ka->ws + WS_BIG);
        const int gt = F.vcu * (NWAVES * 64) + F.tid, NT = F.G * NWAVES * 64;
        for (int it = gt; it < 32768; it += NT) {
            const int ch = it & 31, rr = (it >> 5) & 511, smp = it >> 14;
            size_t prow; float* dst;
            const int isv = ch >> 4, c8 = (ch & 15) * 8;
            if (!smp) { const int n = rr >> 7, j = rr & 127; prow = (size_t)(n * SEQ + 3968 + j); dst = F.ka->out + (isv ? O_VP : O_KP) + ((size_t)n * 128 + j) * 128 + c8; }
            else { const int s = rr >> 2, i = rr & 3; prow = (size_t)(MP + rr); dst = F.ka->out + (isv ? O_VS : O_KS) + ((size_t)s * 128 + 124 + i) * 128 + c8; }
            const v4u w = *(const GAS v4u*)(P + prow * NPROJ + C_KA + isv * 128 + c8);
            *(GAS f32x4*)dst = (f32x4){bflo(w.x), bfhi(w.x), bflo(w.y), bfhi(w.y)}; *(GAS f32x4*)(dst + 4) = (f32x4){bflo(w.z), bfhi(w.z), bflo(w.w), bfhi(w.w)};
        }
    }
    __syncthreads();
    for (int u = F.vcu; u < 1024; u += F.G) gla_u_unit(F, u);
}

__device__ __forceinline__ void ffn_fixup_phase(Frame& F, const float* cw, const float* cb) {
    const bf16* US = (const bf16*)(F.ka->ws + WS_MO); bf16* ACT = (bf16*)(F.ka->ws + WS_BIG);
    const int gt = F.vcu * (NWAVES * 64) + F.tid, NT = F.G * NWAVES * 64;
    for (int it = gt; it < 256 * 704; it += NT) {
        const int grp = it / 704, ch = (it % 704) * 4;
        float a[2][4] = {{1.f, 1.f, 1.f, 1.f}, {1.f, 1.f, 1.f, 1.f}};
#pragma unroll
        for (int half = 0; half < 2; ++half) {
            const int col = half * FF + ch;
            float u62[4] = {0.f, 0.f, 0.f, 0.f}, u63[4] = {0.f, 0.f, 0.f, 0.f}, u0[4], u1[4];
            if ((grp & 63) != 0) { const u32x2 w62 = *(const GAS u32x2*)(US + ((size_t)(grp - 1) * 4 + 0) * F2 + col), w63 = *(const GAS u32x2*)(US + ((size_t)(grp - 1) * 4 + 1) * F2 + col);
                u62[0] = bflo(w62.x); u62[1] = bfhi(w62.x); u62[2] = bflo(w62.y); u62[3] = bfhi(w62.y); u63[0] = bflo(w63.x); u63[1] = bfhi(w63.x); u63[2] = bflo(w63.y); u63[3] = bfhi(w63.y); }
            { const u32x2 w0 = *(const GAS u32x2*)(US + ((size_t)grp * 4 + 2) * F2 + col), w1 = *(const GAS u32x2*)(US + ((size_t)grp * 4 + 3) * F2 + col);
                u0[0] = bflo(w0.x); u0[1] = bfhi(w0.x); u0[2] = bflo(w0.y); u0[3] = bfhi(w0.y); u1[0] = bflo(w1.x); u1[1] = bfhi(w1.x); u1[2] = bflo(w1.y); u1[3] = bfhi(w1.y); }
            const f32x4 c0 = *(const GAS f32x4*)(cw + col), c1 = *(const GAS f32x4*)(cw + F2 + col), c2 = *(const GAS f32x4*)(cw + 2 * F2 + col), bb = *(const GAS f32x4*)(cb + col);
#pragma unroll
            for (int i = 0; i < 4; ++i) {
                const float r0 = c0[i] * u62[i] + c1[i] * u63[i] + c2[i] * u0[i] + bb[i], r1 = c0[i] * u63[i] + c1[i] * u0[i] + c2[i] * u1[i] + bb[i];
                if (half == 0) { a[0][i] = pg8::gelu_tanh(r0); a[1][i] = pg8::gelu_tanh(r1); } else { a[0][i] *= r0; a[1][i] *= r1; }
            }
        }
        u32x2 w; w.x = pk2(a[0][0], a[0][1]); w.y = pk2(a[0][2], a[0][3]); *(GAS u32x2*)(ACT + (size_t)(grp * 64) * FF + ch) = w;
        w.x = pk2(a[1][0], a[1][1]); w.y = pk2(a[1][2], a[1][3]); *(GAS u32x2*)(ACT + (size_t)(grp * 64 + 1) * FF + ch) = w;
    }
}

__device__ __forceinline__ void odd_conv_phase(Frame& F) {
    const bf16* P3 = (const bf16*)(F.ka->ws + WS_BIG); bf16* Z = (bf16*)(F.ka->ws + WS_MIX);
    const float* cw = F.ka->in[18]; const float* past = F.ka->in[5];
    const int gt = F.vcu * (NWAVES * 64) + F.tid, NT = F.G * NWAVES * 64;
    for (int it = gt; it < M * 128; it += NT) {
        const int row = it >> 7, c8 = (it & 127) * 8;
        float w[3][8];
#pragma unroll
        for (int d = 0; d < 3; ++d) {
            const int back = 2 - d; bool have; int rr = row - back;
            if (row < MP) have = ((row & (SEQ - 1)) >= back); else have = (((row - MP) & 3) >= back);
            if (have) { const v4u cg = *(const GAS v4u*)(P3 + (size_t)rr * 3072 + 1024 + c8), uu = *(const GAS v4u*)(P3 + (size_t)rr * 3072 + 2048 + c8);
                w[d][0] = bflo(cg.x) * bflo(uu.x); w[d][1] = bfhi(cg.x) * bfhi(uu.x); w[d][2] = bflo(cg.y) * bflo(uu.y); w[d][3] = bfhi(cg.y) * bfhi(uu.y);
                w[d][4] = bflo(cg.z) * bflo(uu.z); w[d][5] = bfhi(cg.z) * bfhi(uu.z); w[d][6] = bflo(cg.w) * bflo(uu.w); w[d][7] = bfhi(cg.w) * bfhi(uu.w); }
            else if (row < MP) {
#pragma unroll
                for (int i = 0; i < 8; ++i) w[d][i] = 0.f; }
            else { const int s = (row - MP) >> 2, tok = (row - MP) & 3; const int pr = 2 + tok - back;
                const f32x4 a = *(const GAS f32x4*)(past + ((size_t)s * 2 + pr) * D + c8), b = *(const GAS f32x4*)(past + ((size_t)s * 2 + pr) * D + c8 + 4);
                w[d][0] = a.x; w[d][1] = a.y; w[d][2] = a.z; w[d][3] = a.w; w[d][4] = b.x; w[d][5] = b.y; w[d][6] = b.z; w[d][7] = b.w; }
        }
        const v4u bg = *(const GAS v4u*)(P3 + (size_t)row * 3072 + c8);
        const float bgv[8] = {bflo(bg.x), bfhi(bg.x), bflo(bg.y), bfhi(bg.y), bflo(bg.z), bfhi(bg.z), bflo(bg.w), bfhi(bg.w)};
        float o[8];
#pragma unroll
        for (int i = 0; i < 8; ++i) o[i] = bgv[i] * (cw[c8 + i] * w[0][i] + cw[D + c8 + i] * w[1][i] + cw[2 * D + c8 + i] * w[2][i]);
        v4u ow; ow.x = pk2(o[0], o[1]); ow.y = pk2(o[2], o[3]); ow.z = pk2(o[4], o[5]); ow.w = pk2(o[6], o[7]);
        *(GAS v4u*)(Z + (size_t)row * D + c8) = ow;
        float* dst = nullptr;
        if (row < MP) { const int t = row & (SEQ - 1); if (t >= SEQ - 2) dst = F.ka->out + O_CP + ((size_t)(row >> 12) * 2 + (t - (SEQ - 2))) * D + c8; }
        else { const int s = (row - MP) >> 2, tok = (row - MP) & 3; if (tok >= 2) dst = F.ka->out + O_CS + ((size_t)s * 2 + (tok - 2)) * D + c8; }
        if (dst) { *(GAS f32x4*)dst = (f32x4){w[2][0], w[2][1], w[2][2], w[2][3]}; *(GAS f32x4*)(dst + 4) = (f32x4){w[2][4], w[2][5], w[2][6], w[2][7]}; }
    }
}
#define FFN_LAYER(l) do { \
        { pg8::Gemm g{(const bf16*)(F.ka->ws + WS_XN), (const bf16*)(F.ka->ws + WS_WUP) + (size_t)(l) * F2 * D, M, F2, D}; pg8::StaticOrder S; S.init(M, F2, F.G, (int)blockIdx.x); \
          pg8::EpiFfnUp E{(bf16*)(F.ka->ws + WS_BIG), (bf16*)(F.ka->ws + WS_MO), F.ka->in[21] + (size_t)(l) * 3 * F2, F.ka->in[22] + (size_t)(l) * F2, F.ka->in[6] + (size_t)(l) * 128 * 2 * F2, F.ka->out + O_FP + (size_t)(l) * 4 * 2 * F2, F.ka->out + O_FS + (size_t)(l) * 128 * 2 * F2}; \
          if (PH(8)) pg8::gemm_phase<pg8::EpiFfnUp, pg8::StaticOrder, true, true>(F.lds, g, S, E); } \
        GRID_BAR(); \
        if (PH(9)) ffn_fixup_phase(F, F.ka->in[21] + (size_t)(l) * 3 * F2, F.ka->in[22] + (size_t)(l) * F2); \
        GRID_BAR(); \
        { pg8::Gemm g{(const bf16*)(F.ka->ws + WS_BIG), (const bf16*)(F.ka->ws + WS_WDN) + (size_t)(l) * D * FF, M, D, FF}; pg8::StaticOrder S; S.init(M, D, F.G, (int)blockIdx.x); \
          pg8::EpiStore E{(bf16*)(F.ka->ws + WS_MO), D}; \
          if (PH(5)) pg8::gemm_phase<pg8::EpiStore, pg8::StaticOrder, true, true>(F.lds, g, S, E); } \
    } while (0)
__global__ void __launch_bounds__(NWAVES * 64, 2) trunk_fwd(Args args) {
    extern __shared__ __attribute__((aligned(16))) unsigned char lds[];
    Frame F;
    F.lds = (LAS unsigned char*)lds;
    F.MISC = (volatile LAS unsigned*)(F.lds + MISC_OFF);
    F.tid = threadIdx.x; F.lane = F.tid & 63; F.wave = __builtin_amdgcn_readfirstlane(F.tid >> 6);
    F.G = gridDim.x; { const int bx = blockIdx.x; F.vcu = (F.G % 8 == 0) ? (bx % 8) * (F.G / 8) + bx / 8 : bx; }
    F.ctl = (gu32*)(args.ws + WS_CTL);
    for (int u = F.tid; u < (LDS_BYTES - LDSCTL_OFF) / 4; u += NWAVES * 64) ((LAS unsigned*)(F.lds + LDSCTL_OFF))[u] = 0u;
    __syncthreads();
    (void)xcd_barrier_post((unsigned*)(F.ctl + CW_BAR), F.MISC + 8);
#define GRID_BAR() do { XcdBarrier bar_; bar_.bar = (unsigned*)((gu32*)(F.ka->ws + WS_CTL) + CW_BAR); bar_.x = xb_xcc_id(); bar_.st = (volatile LAS unsigned*)(F.lds + MISC_OFF) + 8; xcd_barrier(bar_); F.ka = fresh_kargs(); } while (0)
    F.ka = fresh_kargs();
#ifndef PHMASK
#define PHMASK 0xFFFF
#endif
#define PH(k) ((PHMASK >> (k)) & 1)
    if (PH(0)) p0_prologue(F);
    GRID_BAR();
    {
        pg8::Gemm g{(const bf16*)(F.ka->ws + WS_XN), (const bf16*)(F.ka->ws + WS_W1), M, NPROJ, D}; pg8::StaticOrder S; S.init(M, NPROJ, F.G, (int)blockIdx.x);
        pg8::EpiProj E{(bf16*)(F.ka->ws + WS_BIG), (float*)(F.ka->ws + WS_GB), F.ka->in[13], QA_SCALE, QB_SCALE};
        if (PH(1)) pg8::gemm_phase<pg8::EpiProj, pg8::StaticOrder, true, true>(F.lds, g, S, E);
    }
    GRID_BAR();
    if (PH(2)) mixer_phase1(F);
    GRID_BAR();
    if (PH(3)) gla_scan_phase(F);
    GRID_BAR();
    if (PH(4)) for (int u = F.vcu; u < 1024; u += F.G) gla_out_unit(F, u);
    GRID_BAR();
    {
        pg8::Gemm g{(const bf16*)(F.ka->ws + WS_MIX), (const bf16*)(F.ka->ws + WS_WOE), M, D, D}; pg8::StaticOrder S; S.init(M, D, F.G, (int)blockIdx.x);
        pg8::EpiStore E{(bf16*)(F.ka->ws + WS_MO), D};
        if (PH(5)) pg8::gemm_phase<pg8::EpiStore, pg8::StaticOrder, true, true>(F.lds, g, S, E);
    }
    GRID_BAR();
    if (PH(6)) rowwise_phase<true, false>(F, F.ka->in[8], F.ka->in[9]);
    GRID_BAR();
    FFN_LAYER(0);
    GRID_BAR();
    if (PH(6)) rowwise_phase<false, false>(F, F.ka->in[10], F.ka->in[7] + D);
    GRID_BAR();
    {
        pg8::Gemm g{(const bf16*)(F.ka->ws + WS_XN), (const bf16*)(F.ka->ws + WS_WIO), M, 3072, D}; pg8::StaticOrder S; S.init(M, 3072, F.G, (int)blockIdx.x);
        pg8::EpiStore E{(bf16*)(F.ka->ws + WS_BIG), 3072};
        if (PH(5)) pg8::gemm_phase<pg8::EpiStore, pg8::StaticOrder, true, true>(F.lds, g, S, E);
    }
    GRID_BAR();
    if (PH(7)) odd_conv_phase(F);
    GRID_BAR();
    {
        pg8::Gemm g{(const bf16*)(F.ka->ws + WS_MIX), (const bf16*)(F.ka->ws + WS_WOO), M, D, D}; pg8::StaticOrder S; S.init(M, D, F.G, (int)blockIdx.x);
        pg8::EpiStore E{(bf16*)(F.ka->ws + WS_MO), D};
        if (PH(5)) pg8::gemm_phase<pg8::EpiStore, pg8::StaticOrder, true, true>(F.lds, g, S, E);
    }
    GRID_BAR();
    if (PH(6)) rowwise_phase<false, false>(F, F.ka->in[8] + D, F.ka->in[9] + D);
    GRID_BAR();
    FFN_LAYER(1);
    GRID_BAR();
    if (PH(6)) rowwise_phase<false, true>(F, F.ka->in[10] + D, nullptr);
#undef GRID_BAR
}

extern "C" void kernel_launch(void* const* d_in, const int* in_sizes, int n_in, void* d_out, int out_size, void* d_ws, size_t ws_size, hipStream_t stream) {
    static int grid = 0;
    if (grid == 0) {
        if (n_in != 24 || in_sizes[0] != MP * D || (size_t)out_size != O_END || ws_size < WS_END) {
            fprintf(stderr, "kernel_launch: unexpected shapes (n_in %d, in0 %d, out %d, ws %zu); nothing launched\n", n_in, n_in > 0 ? in_sizes[0] : -1, out_size, ws_size); grid = -1; return; }
        int dev = 0, cus = 0, per_cu = 0;
        if (hipGetDevice(&dev) != hipSuccess || hipDeviceGetAttribute(&cus, hipDeviceAttributeMultiprocessorCount, dev) != hipSuccess) { fprintf(stderr, "kernel_launch: device query failed\n"); grid = -1; return; }
        if (hipFuncSetAttribute((const void*)trunk_fwd, hipFuncAttributeMaxDynamicSharedMemorySize, LDS_BYTES) != hipSuccess) { fprintf(stderr, "kernel_launch: hipFuncSetAttribute failed\n"); grid = -1; return; }
        if (hipOccupancyMaxActiveBlocksPerMultiprocessor(&per_cu, (const void*)trunk_fwd, NWAVES * 64, LDS_BYTES) != hipSuccess || per_cu < 1) { fprintf(stderr, "kernel_launch: occupancy query reports %d blocks per CU\n", per_cu); (void)hipGetLastError(); grid = -1; return; }
        grid = cus;
    }
    if (grid < 0) return;
    if (hipMemsetAsync((char*)d_ws + WS_CTL, 0, CTL_ZERO_BYTES, stream) != hipSuccess) { fprintf(stderr, "kernel_launch: memset failed\n"); return; }
    Args a{};
    for (int i = 0; i < 24; ++i) a.in[i] = (const float*)d_in[i];
    a.out = (float*)d_out; a.ws = (unsigned char*)d_ws;
    hipLaunchKernelGGL(trunk_fwd, dim3(grid), dim3(NWAVES * 64), LDS_BYTES, stream, a);
    const hipError_t le = hipPeekAtLastError();
    if (le != hipSuccess) fprintf(stderr, "kernel_launch: launch failed: %s\n", hipGetErrorName(le));
}
```
